# Optimizing an MI355X kernel written in HIP

```python
import jax, jax.numpy as jnp
from jax import lax
import numpy as np


D_MODEL = 1024
BATCH = 4
SEQ = 4096
DEPTH = 1
DEC_BATCH = 8
DEC_SEQ = 64
PAST_LEN = 2048

CHUNK = 64
Q_BLOCK = 128
SB_HEAD_DIM = 64
SB_WIDTH = D_MODEL // 2
SB_HEADS = SB_WIDTH // SB_HEAD_DIM
SGU_GROUP_DIM = 64
SGU_WIDTH = D_MODEL - SB_WIDTH
SGU_GROUPS = SGU_WIDTH // SGU_GROUP_DIM
SGU_CHUNK = 128
D_MIX = SB_WIDTH + SGU_WIDTH
D_IN = 3 * SB_WIDTH + 2 * SGU_WIDTH
D_FF = 2816
FFN_RES = 0.5
EPS = 1e-6

kernel_name = 'stickbreak_sgu_macaron_stream_step'


def rms_norm(x, g):
    xf = x.astype(jnp.float32)
    y = xf * lax.rsqrt(jnp.mean(xf * xf, axis=-1, keepdims=True) + EPS)
    return (y * g.astype(jnp.float32)).astype(x.dtype)


def layer_norm(x, g, b):
    xf = x.astype(jnp.float32)
    mu = jnp.mean(xf, axis=-1, keepdims=True)
    xc = xf - mu
    y = xc * lax.rsqrt(jnp.mean(xc * xc, axis=-1, keepdims=True) + EPS)
    return (y * g.astype(jnp.float32) + b.astype(jnp.float32)).astype(x.dtype)


def macaron_ffn(x, pre_g, post_g, w_gate, w_up, w_down):
    h = rms_norm(x, pre_g)
    f = (jax.nn.silu(h @ w_gate) * (h @ w_up)) @ w_down
    return x + FFN_RES * rms_norm(f, post_g)


def stick_breaking_block(q, k, v, q_pos, k_pos):
    z = jnp.einsum('bqhd,bkhd->bhqk', q.astype(jnp.float32), k.astype(jnp.float32)) * (SB_HEAD_DIM ** -0.5)
    mask = k_pos[None, :] < q_pos[:, None]
    log_1m = jnp.where(mask, jax.nn.log_sigmoid(-z), 0.0)
    suffix = lax.cumsum(log_1m, axis=3, reverse=True)
    between = jnp.concatenate([suffix[..., 1:], jnp.zeros_like(suffix[..., :1])], axis=-1)
    a = jnp.where(mask, jnp.exp(jax.nn.log_sigmoid(z) + between), 0.0)
    return jnp.einsum('bhqk,bkhd->bqhd', a, v.astype(jnp.float32)).astype(v.dtype)


def stick_breaking_prompt(q, k, v):
    B, S, H, d = q.shape
    n_blk = S // Q_BLOCK
    k_pos = jnp.arange(S)
    q_blocks = q.reshape(B, n_blk, Q_BLOCK, H, d).swapaxes(0, 1)

    def one_block(args):
        q_blk, i = args
        q_pos = i * Q_BLOCK + jnp.arange(Q_BLOCK)
        return stick_breaking_block(q_blk, k, v, q_pos, k_pos)

    o = lax.map(one_block, (q_blocks, jnp.arange(n_blk)))
    return o.swapaxes(0, 1).reshape(B, S, H, d)


def stick_breaking_sample(q, k_new, v_new, past_k, past_v):
    P = past_k.shape[1]
    T = q.shape[1]
    k_all = jnp.concatenate([past_k.astype(k_new.dtype), k_new], axis=1)
    v_all = jnp.concatenate([past_v.astype(v_new.dtype), v_new], axis=1)
    q_pos = P + jnp.arange(T)
    k_pos = jnp.arange(P + T)
    return stick_breaking_block(q, k_all, v_all, q_pos, k_pos)


def sgu_mask(n):
    i = jnp.arange(n)
    return (i[None, :] // CHUNK) <= (i[:, None] // CHUNK)


def sgu_prompt(u, g, w_s, b_s):
    B, S = u.shape[:2]
    n = S // SGU_CHUNK
    gc = g.reshape(B, n, SGU_CHUNK, SGU_GROUPS, SGU_GROUP_DIM)
    w = w_s * sgu_mask(SGU_CHUNK)[None].astype(w_s.dtype)
    mixed = jnp.einsum('gij,bcjgd->bcigd', w, gc) + b_s.T[None, None, :, :, None]
    return u * mixed.reshape(B, S, SGU_WIDTH)


def sgu_sample(u, g, w_s, b_s):
    B, T = u.shape[:2]
    w = (w_s * sgu_mask(SGU_CHUNK)[None].astype(w_s.dtype))[:, :T, :T]
    mixed = jnp.einsum('gij,bjgd->bigd', w, g) + b_s[:, :T].T[None, :, :, None]
    return u * mixed.reshape(B, T, SGU_WIDTH)


def token_mix(x, p, past_k, past_v):
    B, T, _ = x.shape
    h = rms_norm(x, p['mix_pre_g'])
    z = h @ p['w_in']
    q, k, v, u, g = jnp.split(z, [SB_WIDTH, 2 * SB_WIDTH, 3 * SB_WIDTH, 3 * SB_WIDTH + SGU_WIDTH], axis=-1)
    q = q.reshape(B, T, SB_HEADS, SB_HEAD_DIM)
    k = k.reshape(B, T, SB_HEADS, SB_HEAD_DIM)
    v = v.reshape(B, T, SB_HEADS, SB_HEAD_DIM)
    u = jax.nn.gelu(u, approximate=False)
    g = layer_norm(jax.nn.gelu(g, approximate=False), p['sgu_ln_g'], p['sgu_ln_b'])
    g = g.reshape(B, T, SGU_GROUPS, SGU_GROUP_DIM)
    if past_k is None:
        o_sb = stick_breaking_prompt(q, k, v)
        o_sgu = sgu_prompt(u, g, p['sgu_w_s'], p['sgu_b_s'])
    else:
        o_sb = stick_breaking_sample(q, k, v, past_k, past_v)
        o_sgu = sgu_sample(u, g, p['sgu_w_s'], p['sgu_b_s'])
    merged = jnp.concatenate([rms_norm(o_sb.reshape(B, T, SB_WIDTH), p['g_out_sb']),
                              rms_norm(o_sgu, p['g_out_sgu'])], axis=-1)
    x = x + rms_norm(merged @ p['w_out'], p['mix_post_g'])
    return x, k, v, g


def encoder_layer(x, p, past_k, past_v):
    x = macaron_ffn(x, p['ffn1_pre_g'], p['ffn1_post_g'], p['ffn1_w_gate'], p['ffn1_w_up'], p['ffn1_w_down'])
    x, k, v, g = token_mix(x, p, past_k, past_v)
    x = macaron_ffn(x, p['ffn2_pre_g'], p['ffn2_post_g'], p['ffn2_w_gate'], p['ffn2_w_up'], p['ffn2_w_down'])
    return x, k, v, g


def setup_inputs(seed: int = 0) -> dict:
    key = jax.random.key(seed)
    ks = jax.random.split(key, 24)
    L = DEPTH

    def nrm(k, shape, scale):
        return scale * jax.random.normal(k, shape, jnp.float32)

    def gain(k, n):
        return 1.0 + 0.02 * jax.random.normal(k, (L, n), jnp.float32)

    return {
        'x_prompt': nrm(ks[0], (BATCH, SEQ, D_MODEL), 1.0),
        'x_sample': nrm(ks[1], (DEC_BATCH, DEC_SEQ, D_MODEL), 1.0),
        'cache_k_sb': nrm(ks[2], (L, DEC_BATCH, PAST_LEN, SB_HEADS, SB_HEAD_DIM), 1.0),
        'cache_v_sb': nrm(ks[3], (L, DEC_BATCH, PAST_LEN, SB_HEADS, SB_HEAD_DIM), 1.0),
        'ffn1_pre_g': gain(ks[4], D_MODEL),
        'ffn1_post_g': gain(ks[5], D_MODEL),
        'ffn1_w_gate': nrm(ks[6], (L, D_MODEL, D_FF), D_MODEL ** -0.5),
        'ffn1_w_up': nrm(ks[7], (L, D_MODEL, D_FF), D_MODEL ** -0.5),
        'ffn1_w_down': nrm(ks[8], (L, D_FF, D_MODEL), D_FF ** -0.5),
        'mix_pre_g': gain(ks[9], D_MODEL),
        'mix_post_g': gain(ks[10], D_MODEL),
        'w_in': nrm(ks[11], (L, D_MODEL, D_IN), D_MODEL ** -0.5),
        'sgu_ln_g': gain(ks[12], SGU_WIDTH),
        'sgu_ln_b': nrm(ks[13], (L, SGU_WIDTH), 0.02),
        'sgu_w_s': nrm(ks[14], (L, SGU_GROUPS, SGU_CHUNK, SGU_CHUNK), SGU_CHUNK ** -0.5),
        'sgu_b_s': 1.0 + nrm(ks[15], (L, SGU_GROUPS, SGU_CHUNK), 0.02),
        'g_out_sb': gain(ks[16], SB_WIDTH),
        'g_out_sgu': gain(ks[17], SGU_WIDTH),
        'w_out': nrm(ks[18], (L, D_MIX, D_MODEL), D_MIX ** -0.5),
        'ffn2_pre_g': gain(ks[19], D_MODEL),
        'ffn2_post_g': gain(ks[20], D_MODEL),
        'ffn2_w_gate': nrm(ks[21], (L, D_MODEL, D_FF), D_MODEL ** -0.5),
        'ffn2_w_up': nrm(ks[22], (L, D_MODEL, D_FF), D_MODEL ** -0.5),
        'ffn2_w_down': nrm(ks[23], (L, D_FF, D_MODEL), D_FF ** -0.5),
    }


def reference(x_prompt, x_sample, cache_k_sb, cache_v_sb,
              ffn1_pre_g, ffn1_post_g, ffn1_w_gate, ffn1_w_up, ffn1_w_down,
              mix_pre_g, mix_post_g, w_in, sgu_ln_g, sgu_ln_b, sgu_w_s, sgu_b_s,
              g_out_sb, g_out_sgu, w_out,
              ffn2_pre_g, ffn2_post_g, ffn2_w_gate, ffn2_w_up, ffn2_w_down):
    params = {
        'ffn1_pre_g': ffn1_pre_g, 'ffn1_post_g': ffn1_post_g,
        'ffn1_w_gate': ffn1_w_gate, 'ffn1_w_up': ffn1_w_up, 'ffn1_w_down': ffn1_w_down,
        'mix_pre_g': mix_pre_g, 'mix_post_g': mix_post_g, 'w_in': w_in,
        'sgu_ln_g': sgu_ln_g, 'sgu_ln_b': sgu_ln_b, 'sgu_w_s': sgu_w_s, 'sgu_b_s': sgu_b_s,
        'g_out_sb': g_out_sb, 'g_out_sgu': g_out_sgu, 'w_out': w_out,
        'ffn2_pre_g': ffn2_pre_g, 'ffn2_post_g': ffn2_post_g,
        'ffn2_w_gate': ffn2_w_gate, 'ffn2_w_up': ffn2_w_up, 'ffn2_w_down': ffn2_w_down,
    }
    xp = x_prompt
    xs = x_sample
    k_p, v_p, k_s, v_s, g_s = [], [], [], [], []
    for l in range(DEPTH):
        p = {name: arr[l] for name, arr in params.items()}
        xp, kp, vp, _ = encoder_layer(xp, p, None, None)
        xs, kq, vq, gq = encoder_layer(xs, p, cache_k_sb[l], cache_v_sb[l])
        k_p.append(kp)
        v_p.append(vp)
        k_s.append(kq)
        v_s.append(vq)
        g_s.append(gq)
    return (xp, xs, jnp.stack(k_p), jnp.stack(v_p), jnp.stack(k_s), jnp.stack(v_s), jnp.stack(g_s))
```

```cpp
#include <hip/hip_runtime.h>
#include <cstdio>
#include <cstdint>
namespace pg8 {
#define PG8_LAS __attribute__((address_space(3)))
typedef unsigned short bf16_t;
typedef short bf16x8 __attribute__((ext_vector_type(8)));
typedef float f32x4 __attribute__((ext_vector_type(4)));
typedef unsigned u32x4 __attribute__((ext_vector_type(4)));
constexpr int BM = 256, BK = 64, HALF = 128, HTB = HALF * BK * 2  , STAGE_BYTES = 8 * HTB, NXCD = 8, WGM = 8;

__host__ __device__ __forceinline__ int lds_byte(int r, int c) { const int st = (r >> 4) * 2 + (c >> 5), rr = r & 15, cc = c & 31, ob = rr * 64 + cc * 2; return st * 1024 + (ob ^ (((ob >> 9) & 1) << 5)); }
__host__ __device__ __forceinline__ void stage_rc(int b, int& R, int& C) { const int st = b / 1024, sb = b % 1024, swz = sb ^ (((sb >> 9) & 1) << 5); R = (st >> 1) * 16 + swz / 64; C = (st & 1) * 32 + (swz % 64) / 2; }
__host__ __device__ __forceinline__ int perm32(int rho) { const int n = rho >> 4, i = rho & 15; return 8 * (i >> 2) + 4 * n + (i & 3); }

struct Unit { int pm, pn; };
struct Gemm { const bf16_t* A; const bf16_t* Bt; int M, N, K; };

struct StaticOrder {
    int nM, nN, nwg, G, c;
    __host__ __device__ void init(int M, int N, int G_, int c_) { nM = M / BM; nN = N / BM; nwg = nM * nN; G = G_; c = c_; }
    __host__ __device__ bool next(int i, Unit& u) const {
        const long L = (long)i * G + c; if (L >= nwg) return false;
        int wgid = (int)L; { const int q = nwg / NXCD, r = nwg % NXCD, xcd = wgid % NXCD, off = wgid / NXCD; wgid = (xcd < r ? xcd * (q + 1) : r * (q + 1) + (xcd - r) * q) + off; }
        const int nig = WGM * nN, gid = wgid / nig, fm = gid * WGM, gsz = (nM - fm) < WGM ? (nM - fm) : WGM;
        u.pm = fm + ((wgid % nig) % gsz); u.pn = (wgid % nig) / gsz; return true;
    }
    __device__ __forceinline__ void a_ready(const Unit&) const {}
    __device__ __forceinline__ void done(const Unit&) const {}
};

__device__ __forceinline__ unsigned cvt_pk_bf16(float lo, float hi) { unsigned r; asm volatile("v_cvt_pk_bf16_f32 %0, %1, %2" : "=v"(r) : "v"(lo), "v"(hi)); return r; }
typedef float f32x2 __attribute__((ext_vector_type(2)));
__device__ __forceinline__ f32x2 gelu_pk(f32x2 v) {
    const f32x2 av = __builtin_elementwise_abs(v), d = av * 0.2316418882f + 1.0f;
    f32x2 t; t.x = __builtin_amdgcn_rcpf(d.x); t.y = __builtin_amdgcn_rcpf(d.y);
    f32x2 q = t * 0.5307027145f + (-0.7265760135f); q = q * t + 0.7107068705f; q = q * t + (-0.142248368f); q = q * t + 0.127414796f; q = q * t;
    const f32x2 s = (v * v) * (-0.72134752044f);
    f32x2 e; e.x = __builtin_amdgcn_exp2f(s.x); e.y = __builtin_amdgcn_exp2f(s.y);
    const f32x2 m = v * (q * e), r = v - m;
    f32x2 o; o.x = v.x < 0.f ? m.x : r.x; o.y = v.y < 0.f ? m.y : r.y; return o;
}

template <int ACT  > struct EpiBf16 {
    static constexpr bool PERM = true, AFTER_DRAIN = false; static_assert(ACT == 0 || ACT == 1, "EpiBf16: ACT is 0 (none) or 1 (gelu_pk)");
    bf16_t* O; int ldc; const float* bias; int split_cols; size_t split_stride; float scale0;
    __device__ __forceinline__ void operator()(const f32x4 (&acc)[2][2][4][2], const Unit& u, int wr, int wc, int fr, int fq) const {
        const int row0 = u.pm * BM + wr * 64 + fr; int colt = u.pn * BM; bf16_t* base = O;
        float sc = 1.f; if (split_cols) { const int t = colt / split_cols; base += (size_t)t * split_stride; colt -= t * split_cols; if (t == 0) sc = scale0; }
        const int col0 = colt + wc * 32 + 8 * fq, bcol0 = u.pn * BM + wc * 32 + 8 * fq;
        f32x4 bv[2][2];
#pragma unroll
        for (int bj = 0; bj < 2; ++bj)
#pragma unroll
            for (int n = 0; n < 2; ++n) bv[bj][n] = bias ? *(const f32x4*)(bias + bcol0 + bj * HALF + 4 * n) : (f32x4){0.f, 0.f, 0.f, 0.f};
#pragma unroll
        for (int ai = 0; ai < 2; ++ai)
#pragma unroll
            for (int m = 0; m < 4; ++m) { bf16_t* rowp = base + (size_t)(row0 + ai * HALF + m * 16) * ldc + col0;
#pragma unroll
                for (int bj = 0; bj < 2; ++bj) { f32x4 v0 = acc[ai][bj][m][0] + bv[bj][0], v1 = acc[ai][bj][m][1] + bv[bj][1];
                    if (ACT == 1) { f32x2 a = gelu_pk((f32x2){v0[0], v0[1]}), b = gelu_pk((f32x2){v0[2], v0[3]}), c = gelu_pk((f32x2){v1[0], v1[1]}), d = gelu_pk((f32x2){v1[2], v1[3]});
                        v0 = (f32x4){a.x, a.y, b.x, b.y}; v1 = (f32x4){c.x, c.y, d.x, d.y}; }
                    v0 = v0 * sc; v1 = v1 * sc; u32x4 w; w.x = cvt_pk_bf16(v0[0], v0[1]); w.y = cvt_pk_bf16(v0[2], v0[3]); w.z = cvt_pk_bf16(v1[0], v1[1]); w.w = cvt_pk_bf16(v1[2], v1[3]);
                    *(u32x4*)(rowp + bj * HALF) = w; } }
    }
};

struct PanelStats {
    unsigned* xbuf;
    unsigned* cnt;
    unsigned* tmo;
    int ntn; float eps;
    unsigned code;
    __device__ __forceinline__ bool run(const f32x4 (&v)[2][2][4][2], const Unit& u, int wr, int wc, int fr, int fq, PG8_LAS unsigned char* lds, int wid, int lane) const {
        typedef float f32x2v __attribute__((ext_vector_type(2)));
        PG8_LAS f32x2v* P = (PG8_LAS f32x2v*)lds;
        PG8_LAS f32x2v* S = (PG8_LAS f32x2v*)(lds + 8192);
        PG8_LAS unsigned* flag = (PG8_LAS unsigned*)(lds + 8192 + 2048);
#pragma unroll
        for (int ai = 0; ai < 2; ++ai)
#pragma unroll
            for (int m = 0; m < 4; ++m) {
                float s = 0.f;
#pragma unroll
                for (int bj = 0; bj < 2; ++bj)
#pragma unroll
                    for (int n = 0; n < 2; ++n) { const f32x4 x = v[ai][bj][m][n]; s += (x[0] + x[1]) + (x[2] + x[3]); }
                s += __shfl_xor(s, 16); s += __shfl_xor(s, 32);
                const float mw = s * (1.0f / 64.0f); float q = 0.f;
#pragma unroll
                for (int bj = 0; bj < 2; ++bj)
#pragma unroll
                    for (int n = 0; n < 2; ++n) { const f32x4 d = v[ai][bj][m][n] - mw; q += (d[0] * d[0] + d[1] * d[1]) + (d[2] * d[2] + d[3] * d[3]); }
                q += __shfl_xor(q, 16); q += __shfl_xor(q, 32);
                if (fq == 0) P[(ai * HALF + wr * 64 + m * 16 + fr) * 4 + wc] = (f32x2v){mw, q};
            }
        asm volatile("s_waitcnt lgkmcnt(0)" ::: "memory"); __builtin_amdgcn_s_barrier(); asm volatile("" ::: "memory");
#if defined(BROKEN_EXCHANGE_NO_WAIT)
#warning BROKEN CONTROL BUILD: the row-statistics exchange does not wait; results are wrong by design
        if (blockIdx.x >= 64) { const long long t0_ = clock64(); while (clock64() - t0_ < 60000) __builtin_amdgcn_s_sleep(8); }
#endif
        const int row = wid * 32 + (lane & 31);
        if (lane < 32) {
            const f32x2v a = P[row * 4 + 0], b = P[row * 4 + 1], c = P[row * 4 + 2], d = P[row * 4 + 3];
            const float mt = (a.x + b.x + c.x + d.x) * 0.25f;
            const float da = a.x - mt, db = b.x - mt, dc = c.x - mt, dd = d.x - mt;
            const float m2 = (a.y + b.y) + (c.y + d.y) + 64.0f * ((da * da + db * db) + (dc * dc + dd * dd));
            unsigned long long* slot = (unsigned long long*)xbuf + ((size_t)(u.pm * BM + row) * 4 + u.pn);
            __hip_atomic_store(slot, ((unsigned long long)__float_as_uint(m2) << 32) | __float_as_uint(mt), __ATOMIC_RELAXED, __HIP_MEMORY_SCOPE_AGENT);
        }
        asm volatile("s_waitcnt vmcnt(0)" ::: "memory");
        if (lane == 0) __hip_atomic_fetch_add(cnt + 64 * u.pm, 1u, __ATOMIC_RELAXED, __HIP_MEMORY_SCOPE_AGENT);
        if (wid == 0) {
            bool dead = false; const unsigned long long t0 = __builtin_amdgcn_s_memrealtime(); const unsigned want = 8u * (unsigned)ntn;
            for (;;) {
#if defined(BROKEN_EXCHANGE_NO_WAIT)
                break;
#endif
                if ((unsigned)__builtin_amdgcn_readfirstlane(__hip_atomic_load(cnt + 64 * u.pm, __ATOMIC_RELAXED, __HIP_MEMORY_SCOPE_AGENT)) >= want) break;
                if (__builtin_amdgcn_s_memrealtime() - t0 > 2000000ull) {
                    if (lane == 0) { unsigned expect = 0u; __hip_atomic_compare_exchange_strong(tmo + 1, &expect, code | (unsigned)(u.pm & 0xff), __ATOMIC_RELAXED, __ATOMIC_RELAXED, __HIP_MEMORY_SCOPE_AGENT);
                                     __hip_atomic_store(tmo, 1u, __ATOMIC_RELAXED, __HIP_MEMORY_SCOPE_AGENT); }
                    dead = true; break; }
                __builtin_amdgcn_s_sleep(2);
            }
            __builtin_amdgcn_fence(__ATOMIC_ACQUIRE, "agent");
            if (lane == 0) flag[0] = dead ? 1u : 0u;
        }
        asm volatile("s_waitcnt vmcnt(0) lgkmcnt(0)" ::: "memory"); __builtin_amdgcn_s_barrier(); asm volatile("" ::: "memory");
        const bool bad = flag[0] != 0u;
        if (lane < 32) {
            const unsigned long long* slot = (const unsigned long long*)xbuf + (size_t)(u.pm * BM + row) * 4; float mt[4], m2[4]; float ms = 0.f;
#pragma unroll
            for (int t = 0; t < 4; ++t) { if (t < ntn) { const unsigned long long w = __hip_atomic_load(slot + t, __ATOMIC_RELAXED, __HIP_MEMORY_SCOPE_AGENT); mt[t] = __uint_as_float((unsigned)w); m2[t] = __uint_as_float((unsigned)(w >> 32)); } else { mt[t] = 0.f; m2[t] = 0.f; } ms += mt[t]; }
            const float mean = ms / (float)ntn; float q = 0.f;
#pragma unroll
            for (int t = 0; t < 4; ++t) if (t < ntn) { const float dm = mt[t] - mean; q += m2[t] + 256.0f * dm * dm; }
            S[row] = (f32x2v){mean, 1.0f / sqrtf(q / (256.0f * (float)ntn) + eps)};
        }
        asm volatile("s_waitcnt lgkmcnt(0)" ::: "memory"); __builtin_amdgcn_s_barrier(); asm volatile("" ::: "memory");
        return bad;
    }
};
struct EpiLnRes {
    static constexpr bool PERM = false, AFTER_DRAIN = true;
    const float* base; float* out; int ldc; const float* bias; PanelStats st; unsigned poison;
    __device__ __forceinline__ void fused(f32x4 (&acc)[2][2][4][2], const Unit& u, int wr, int wc, int fr, int fq, PG8_LAS unsigned char* lds, int wid, int lane) const {
        typedef float f32x2v __attribute__((ext_vector_type(2)));
        const PG8_LAS f32x2v* S = (const PG8_LAS f32x2v*)(lds + 8192);
        const int col0 = u.pn * BM + wc * 32 + 4 * fq;
#pragma unroll
        for (int bj = 0; bj < 2; ++bj)
#pragma unroll
            for (int n = 0; n < 2; ++n) { const f32x4 bv = bias ? *(const f32x4*)(bias + col0 + bj * HALF + n * 16) : (f32x4){0.f, 0.f, 0.f, 0.f};
#pragma unroll
                for (int ai = 0; ai < 2; ++ai)
#pragma unroll
                    for (int m = 0; m < 4; ++m) acc[ai][bj][m][n] += bv; }
        f32x4 pre[4][2][2];
#pragma unroll
        for (int m = 0; m < 4; ++m) { const size_t off = (size_t)(u.pm * BM + wr * 64 + m * 16 + fr) * ldc + col0;
#pragma unroll
            for (int bj = 0; bj < 2; ++bj)
#pragma unroll
                for (int n = 0; n < 2; ++n) pre[m][bj][n] = *(const f32x4*)(base + off + bj * HALF + n * 16); }
        const bool bad = st.run(acc, u, wr, wc, fr, fq, lds, wid, lane) || poison != 0u;
        const float qnan = __builtin_nanf("");
#pragma unroll
        for (int ai = 0; ai < 2; ++ai)
#pragma unroll
            for (int m = 0; m < 4; ++m) { const int r = ai * HALF + wr * 64 + m * 16 + fr; const f32x2v sr = S[r]; const size_t off = (size_t)(u.pm * BM + r) * ldc + col0;
#pragma unroll
                for (int bj = 0; bj < 2; ++bj)
#pragma unroll
                    for (int n = 0; n < 2; ++n) { const f32x4 bs = ai == 0 ? pre[m][bj][n] : *(const f32x4*)(base + off + bj * HALF + n * 16); f32x4 o = bs + (acc[ai][bj][m][n] - sr.x) * sr.y;
                        if (bad) o = (f32x4){qnan, qnan, qnan, qnan}; *(f32x4*)(out + off + bj * HALF + n * 16) = o; }
                if (m & 1) asm volatile("" ::: "memory"); }
    }
};
struct EpiLnResLn {
    static constexpr bool PERM = false, AFTER_DRAIN = true;
    const float* base; float* out; bf16_t* xn; int ldc; const float* bias; PanelStats st1, st2; unsigned poison;
    __device__ __forceinline__ void fused(f32x4 (&acc)[2][2][4][2], const Unit& u, int wr, int wc, int fr, int fq, PG8_LAS unsigned char* lds, int wid, int lane) const {
        typedef float f32x2v __attribute__((ext_vector_type(2))); typedef unsigned u32x2v __attribute__((ext_vector_type(2)));
        const PG8_LAS f32x2v* S = (const PG8_LAS f32x2v*)(lds + 8192);
        const int col0 = u.pn * BM + wc * 32 + 4 * fq;
#pragma unroll
        for (int bj = 0; bj < 2; ++bj)
#pragma unroll
            for (int n = 0; n < 2; ++n) { const f32x4 bv = bias ? *(const f32x4*)(bias + col0 + bj * HALF + n * 16) : (f32x4){0.f, 0.f, 0.f, 0.f};
#pragma unroll
                for (int ai = 0; ai < 2; ++ai)
#pragma unroll
                    for (int m = 0; m < 4; ++m) acc[ai][bj][m][n] += bv; }
        bool bad = st1.run(acc, u, wr, wc, fr, fq, lds, wid, lane) || poison != 0u;
        const float qnan = __builtin_nanf("");
#pragma unroll
        for (int ai = 0; ai < 2; ++ai)
#pragma unroll
            for (int m = 0; m < 4; ++m) { const int r = ai * HALF + wr * 64 + m * 16 + fr; const f32x2v sr = S[r]; const size_t off = (size_t)(u.pm * BM + r) * ldc + col0;
#pragma unroll
                for (int bj = 0; bj < 2; ++bj)
#pragma unroll
                    for (int n = 0; n < 2; ++n) { const f32x4 bs = *(const f32x4*)(base + off + bj * HALF + n * 16); acc[ai][bj][m][n] = bs + (acc[ai][bj][m][n] - sr.x) * sr.y; }
                asm volatile("" : "+v"(acc[ai][0][m][0]), "+v"(acc[ai][0][m][1]), "+v"(acc[ai][1][m][0]), "+v"(acc[ai][1][m][1]));
                if (m & 1) asm volatile("" ::: "memory"); }
        const bool bad1 = bad;
        bad = st2.run(acc, u, wr, wc, fr, fq, lds, wid, lane) || bad;
#pragma unroll
        for (int ai = 0; ai < 2; ++ai)
#pragma unroll
            for (int m = 0; m < 4; ++m) { const int r = ai * HALF + wr * 64 + m * 16 + fr; const f32x2v sr = S[r]; const size_t off = (size_t)(u.pm * BM + r) * ldc + col0;
#pragma unroll
                for (int bj = 0; bj < 2; ++bj)
#pragma unroll
                    for (int n = 0; n < 2; ++n) { const f32x4 x1 = acc[ai][bj][m][n]; *(f32x4*)(out + off + bj * HALF + n * 16) = bad1 ? (f32x4){qnan, qnan, qnan, qnan} : x1;
                        const f32x4 o = (x1 - sr.x) * sr.y; u32x2v w; w.x = cvt_pk_bf16(o[0], o[1]); w.y = cvt_pk_bf16(o[2], o[3]);
                        if (bad) { w.x = 0x7fc07fc0u; w.y = 0x7fc07fc0u; } *(u32x2v*)(xn + off + bj * HALF + n * 16) = w; }
                asm volatile("" ::: "memory"); }
    }
};

template <class Epi, class Sched, bool ALIGN_EPI = false, bool SP2 = false>
__device__ __forceinline__ void gemm_phase(PG8_LAS unsigned char* lds, const Gemm g, const Sched& S, const Epi& E) {
    const int tid = threadIdx.x, wid = __builtin_amdgcn_readfirstlane(tid >> 6), lane = tid & 63, wr = wid >> 2, wc = wid & 3, fr = lane & 15, fq = lane >> 4;
    const int K = g.K, nt = K / BK;
    unsigned voffA[2], voffB[2];
#pragma unroll
    for (int i = 0; i < 2; ++i) { int R, C; stage_rc(tid * 16 + i * 8192, R, C); const int Rb = Epi::PERM ? ((R & ~31) + perm32(R & 31)) : R;
        voffA[i] = (unsigned)(R * K + C) * 2u; voffB[i] = (unsigned)(Rb * K + C) * 2u; }
    const size_t kstep = (size_t)(BK * 2);
    const size_t hstep = (size_t)HALF * K * 2;
    const size_t tstep = 2 * hstep;
    const unsigned ldsw = (unsigned)wid * 1024u;
    const int aoff = lds_byte(wr * 64 + fr, fq * 8), boff = lds_byte(wc * 32 + fr, fq * 8);
#define PG8_SA(b, h) (((b) * 2 + (h)) * HTB)
#define PG8_SB(b, h) ((4 + (b) * 2 + (h)) * HTB)
#define PG8_STAGE(bufoff, gbase, voff) do { _Pragma("unroll") for (int _i = 0; _i < 2; ++_i) \
        __builtin_amdgcn_global_load_lds((const unsigned*)((const char*)(gbase) + (voff)[_i]), (PG8_LAS unsigned*)(lds + (bufoff) + ldsw + _i * 8192), 16, 0, 0); } while (0)
#define PG8_LDA(dst, b, h) do { _Pragma("unroll") for (int m = 0; m < 4; ++m) _Pragma("unroll") for (int k = 0; k < 2; ++k) dst[m][k] = *(const PG8_LAS bf16x8*)(lds + PG8_SA(b, h) + aoff + m * 2048 + k * 1024); } while (0)
#define PG8_LDB(dst, b, h) do { _Pragma("unroll") for (int n = 0; n < 2; ++n) _Pragma("unroll") for (int k = 0; k < 2; ++k) dst[n][k] = *(const PG8_LAS bf16x8*)(lds + PG8_SB(b, h) + boff + n * 2048 + k * 1024); } while (0)
#define PG8_MMA(ai, bj, At, Bt) do { __builtin_amdgcn_s_setprio(1); _Pragma("unroll") for (int m = 0; m < 4; ++m) _Pragma("unroll") for (int n = 0; n < 2; ++n) _Pragma("unroll") for (int k = 0; k < 2; ++k) \
        acc[ai][bj][m][n] = __builtin_amdgcn_mfma_f32_16x16x32_bf16(Bt[n][k], At[m][k], acc[ai][bj][m][n], 0, 0, 0); __builtin_amdgcn_s_setprio(0); } while (0)
#define PG8_WAIT_V(n) asm volatile("s_waitcnt vmcnt(" #n ")" ::: "memory")
#define PG8_WAIT_L(n) asm volatile("s_waitcnt lgkmcnt(" #n ")" ::: "memory")
#define PG8_BAR __builtin_amdgcn_s_barrier()
#define PG8_SCHED __builtin_amdgcn_sched_barrier(0)
    Unit cur, nxt; int ui = 0;
    if (!S.next(0, cur)) return;
    f32x4 acc[2][2][4][2];
#pragma unroll
    for (int a = 0; a < 2; ++a)
#pragma unroll
        for (int b = 0; b < 2; ++b)
#pragma unroll
            for (int m = 0; m < 4; ++m)
#pragma unroll
                for (int n = 0; n < 2; ++n) acc[a][b][m][n] = (f32x4){0.f, 0.f, 0.f, 0.f};
    bf16x8 At[4][2], B0[2][2], B1[2][2];
    const char* cA = (const char*)g.A + (size_t)cur.pm * tstep; const char* cB = (const char*)g.Bt + (size_t)cur.pn * tstep;
    S.a_ready(cur);
    if constexpr (SP2) {
        PG8_STAGE(PG8_SB(0, 0), cB, voffB); PG8_STAGE(PG8_SB(0, 1), cB + hstep, voffB); PG8_STAGE(PG8_SA(0, 0), cA, voffA); PG8_STAGE(PG8_SA(0, 1), cA + hstep, voffA);
        if (wr == 1) PG8_BAR;
        PG8_WAIT_V(2); PG8_BAR;
        PG8_STAGE(PG8_SB(1, 0), cB + kstep, voffB); PG8_STAGE(PG8_SA(1, 0), cA + kstep, voffA); PG8_STAGE(PG8_SB(1, 1), cB + hstep + kstep, voffB);
        PG8_WAIT_V(6); PG8_BAR;
    } else {
        PG8_STAGE(PG8_SB(0, 0), cB, voffB); PG8_STAGE(PG8_SA(0, 0), cA, voffA); PG8_STAGE(PG8_SB(0, 1), cB + hstep, voffB); PG8_STAGE(PG8_SA(0, 1), cA + hstep, voffA);
        if (wr == 1) PG8_BAR;
        PG8_WAIT_V(4); PG8_BAR;
        PG8_STAGE(PG8_SB(1, 0), cB + kstep, voffB); PG8_STAGE(PG8_SA(1, 0), cA + kstep, voffA); PG8_STAGE(PG8_SB(1, 1), cB + hstep + kstep, voffB);
        PG8_WAIT_V(6); PG8_BAR;
    }
    for (;;) {
        const bool has_next = S.next(ui + 1, nxt);
        const char* nA = has_next ? (const char*)g.A + (size_t)nxt.pm * tstep : cA; const char* nB = has_next ? (const char*)g.Bt + (size_t)nxt.pn * tstep : cB;
        for (int t = 0; t < nt; t += 2) {
            const bool last = (t == nt - 2);
            const char* a1 = cA + (size_t)(t + 1) * kstep;
            const char* a2 = last ? nA : cA + (size_t)(t + 2) * kstep; const char* b2 = last ? nB : cB + (size_t)(t + 2) * kstep;
            const char* a3 = a2 + kstep; const char* b3 = b2 + kstep;
            if (last && has_next) S.a_ready(nxt);
            if constexpr (SP2) {
            PG8_LDB(B0, 0, 0); PG8_LDB(B1, 0, 1); PG8_SCHED; PG8_LDA(At, 0, 0); PG8_STAGE(PG8_SA(1, 1), a1 + hstep, voffA);
            PG8_WAIT_V(8); PG8_WAIT_L(0); PG8_BAR; PG8_MMA(0, 0, At, B0); PG8_MMA(0, 1, At, B1); PG8_BAR; PG8_SCHED;
            PG8_LDA(At, 0, 1); PG8_STAGE(PG8_SB(0, 0), b2, voffB); PG8_STAGE(PG8_SB(0, 1), b2 + hstep, voffB); PG8_STAGE(PG8_SA(0, 0), a2, voffA);
            PG8_WAIT_V(8); PG8_WAIT_L(0); PG8_BAR; PG8_MMA(1, 0, At, B0); PG8_MMA(1, 1, At, B1); PG8_BAR; PG8_SCHED;
            PG8_LDB(B0, 1, 0); PG8_LDB(B1, 1, 1); PG8_SCHED; PG8_LDA(At, 1, 0); PG8_STAGE(PG8_SA(0, 1), a2 + hstep, voffA);
            PG8_WAIT_V(8); PG8_WAIT_L(0); PG8_BAR; PG8_MMA(0, 0, At, B0); PG8_MMA(0, 1, At, B1); PG8_BAR; PG8_SCHED;
            PG8_LDA(At, 1, 1); PG8_STAGE(PG8_SB(1, 0), b3, voffB); PG8_STAGE(PG8_SB(1, 1), b3 + hstep, voffB); PG8_STAGE(PG8_SA(1, 0), a3, voffA);
            PG8_WAIT_V(8); PG8_WAIT_L(0); PG8_BAR; PG8_MMA(1, 0, At, B0); PG8_MMA(1, 1, At, B1); PG8_BAR; PG8_SCHED;
            } else {
            PG8_LDB(B0, 0, 0); PG8_SCHED; PG8_LDA(At, 0, 0); PG8_STAGE(PG8_SA(1, 1), a1 + hstep, voffA);
            PG8_WAIT_L(8); PG8_BAR; PG8_WAIT_L(0); PG8_MMA(0, 0, At, B0); PG8_BAR; PG8_SCHED;
            PG8_LDB(B1, 0, 1); PG8_STAGE(PG8_SB(0, 0), b2, voffB);
            PG8_BAR; PG8_WAIT_L(0); PG8_MMA(0, 1, At, B1); PG8_BAR;
            PG8_LDA(At, 0, 1); PG8_STAGE(PG8_SA(0, 0), a2, voffA);
            PG8_BAR; PG8_WAIT_L(0); PG8_MMA(1, 0, At, B0); PG8_BAR; PG8_SCHED;
            PG8_STAGE(PG8_SB(0, 1), b2 + hstep, voffB);
            PG8_WAIT_V(6); PG8_BAR; PG8_MMA(1, 1, At, B1); PG8_BAR;
            PG8_LDB(B0, 1, 0); PG8_SCHED; PG8_LDA(At, 1, 0); PG8_STAGE(PG8_SA(0, 1), a2 + hstep, voffA);
            PG8_WAIT_L(8); PG8_BAR; PG8_WAIT_L(0); PG8_MMA(0, 0, At, B0); PG8_BAR; PG8_SCHED;
            PG8_LDB(B1, 1, 1); PG8_STAGE(PG8_SB(1, 0), b3, voffB);
            PG8_BAR; PG8_WAIT_L(0); PG8_MMA(0, 1, At, B1); PG8_BAR;
            PG8_LDA(At, 1, 1); PG8_STAGE(PG8_SA(1, 0), a3, voffA);
            PG8_BAR; PG8_WAIT_L(0); PG8_MMA(1, 0, At, B0); PG8_BAR; PG8_SCHED;
            PG8_STAGE(PG8_SB(1, 1), b3 + hstep, voffB);
            PG8_WAIT_V(6); PG8_BAR; PG8_MMA(1, 1, At, B1); PG8_BAR;
            }
        }
        if constexpr (ALIGN_EPI) { if (wr == 0) PG8_BAR; }
        if constexpr (!Epi::AFTER_DRAIN) { E(acc, cur, wr, wc, fr, fq); S.done(cur); }
        if (!has_next) break;
#pragma unroll
        for (int a = 0; a < 2; ++a)
#pragma unroll
            for (int b = 0; b < 2; ++b)
#pragma unroll
                for (int m = 0; m < 4; ++m)
#pragma unroll
                    for (int n = 0; n < 2; ++n) acc[a][b][m][n] = (f32x4){0.f, 0.f, 0.f, 0.f};
        cur = nxt; cA = nA; cB = nB; ++ui;
        if constexpr (ALIGN_EPI) { if (wr == 1) PG8_BAR; }
    }
    PG8_WAIT_V(0);
    if constexpr (!ALIGN_EPI) { if (wr == 0) PG8_BAR; }
    PG8_BAR;
    if constexpr (Epi::AFTER_DRAIN) { E.fused(acc, cur, wr, wc, fr, fq, lds, wid, lane); S.done(cur); }
#undef PG8_SA
#undef PG8_SB
#undef PG8_STAGE
#undef PG8_LDA
#undef PG8_LDB
#undef PG8_MMA
#undef PG8_WAIT_V
#undef PG8_WAIT_L
#undef PG8_BAR
#undef PG8_SCHED
}
}

#ifndef PG8_SP2
#define PG8_SP2 true
#endif
#ifndef PG8_ALIGN
#define PG8_ALIGN true
#endif
#include <hip/hip_cooperative_groups.h>
namespace cg = cooperative_groups;

constexpr int DM = 1024, NP = 16384, NS = 512, MTOT = NP + NS, DFF = 2816, DIN = 2560, HW = 512;
constexpr int SEQ = 4096, PAST = 2048, DSEQ = 64, NB = 4, NDB = 8;
constexpr float EPSN = 1e-6f;
constexpr float QSCALE = 0.125f * 1.4426950408889634f;
#ifndef MK_N_LAUNCHES
#define MK_N_LAUNCHES 1
#endif
constexpr int N_PHASES = 12;

#define LAS __attribute__((address_space(3)))
typedef unsigned short bf16;
typedef unsigned u32x4 __attribute__((ext_vector_type(4)));
typedef unsigned u32x2 __attribute__((ext_vector_type(2)));
typedef float f32x4 __attribute__((ext_vector_type(4)));
typedef float f32x2 __attribute__((ext_vector_type(2)));
typedef float f32x16 __attribute__((ext_vector_type(16)));
typedef short bf16x8 __attribute__((ext_vector_type(8)));
typedef __bf16 bf16x2_t __attribute__((ext_vector_type(2)));
#define MFMA32(a, b, c) __builtin_amdgcn_mfma_f32_32x32x16_bf16((a), (b), (c), 0, 0, 0)

__device__ __forceinline__ unsigned cvtpk(float lo, float hi) { f32x2 v = {lo, hi}; bf16x2_t b = __builtin_convertvector(v, bf16x2_t); return __builtin_bit_cast(unsigned, b); }
__device__ __forceinline__ float bflo(unsigned w) { return __uint_as_float(w << 16); }
__device__ __forceinline__ float bfhi(unsigned w) { return __uint_as_float(w & 0xffff0000u); }
__device__ __forceinline__ float bf2f(bf16 v) { return __uint_as_float((unsigned)v << 16); }
__device__ __forceinline__ bf16 f2bf(float f) { return (bf16)(cvtpk(f, 0.f) & 0xffffu); }
__device__ __forceinline__ float wave_sum(float v) {
#pragma unroll
    for (int o = 1; o < 64; o <<= 1) v += __shfl_xor(v, o);
    return v;
}
__device__ __forceinline__ int crow(int r, int hi) { return (r & 3) + 8 * (r >> 2) + 4 * hi; }
__device__ __forceinline__ bf16x8 pack8(float a0, float a1, float a2, float a3, float a4, float a5, float a6, float a7) {
    u32x4 p; p.x = cvtpk(a0, a1); p.y = cvtpk(a2, a3); p.z = cvtpk(a4, a5); p.w = cvtpk(a6, a7); return __builtin_bit_cast(bf16x8, p);
}

constexpr size_t MiB = 1u << 20;
constexpr size_t WS_WGU1 = 2 * MiB;
constexpr size_t WS_WD1 = WS_WGU1 + (size_t)2 * DFF * DM * 2;
constexpr size_t WS_WIN = WS_WD1 + (size_t)DM * DFF * 2;
constexpr size_t WS_WOUT = WS_WIN + (size_t)DIN * DM * 2;
constexpr size_t WS_WGU2 = WS_WOUT + (size_t)DM * DM * 2;
constexpr size_t WS_WD2 = WS_WGU2 + (size_t)2 * DFF * DM * 2;
constexpr size_t WS_WSB = WS_WD2 + (size_t)DM * DFF * 2;
constexpr size_t WS_WEND = WS_WSB + (size_t)8 * 128 * 128 * 2;
static_assert(WS_WEND <= 44 * MiB, "weights");
constexpr size_t WS_XN = 44 * MiB;
constexpr size_t WS_F = 77 * MiB;
constexpr size_t WS_MG = 110 * MiB;
constexpr size_t WS_ACT = 143 * MiB;
constexpr size_t WS_Q = WS_ACT, SZ_H = (size_t)MTOT * HW * 2;
constexpr size_t WS_K = WS_Q + SZ_H, WS_V = WS_K + SZ_H, WS_U = WS_V + SZ_H, WS_G = WS_U + SZ_H;
static_assert(WS_G + SZ_H <= WS_ACT + (size_t)MTOT * DFF * 2 && WS_ACT + (size_t)MTOT * DFF * 2 <= 234 * MiB, "ws map");
constexpr size_t WS_END = 234 * MiB;

constexpr size_t O_Y = 0, O_KP = (size_t)MTOT * DM, O_VP = O_KP + (size_t)NP * HW, O_KS = O_VP + (size_t)NP * HW, O_VS = O_KS + (size_t)NS * HW, O_GS = O_VS + (size_t)NS * HW;

constexpr int LDS_BYTES = 147456;

namespace pg8 {
struct EpiSwiGLU {
    static constexpr bool PERM = true, AFTER_DRAIN = false;
    bf16_t* O; int ldc;
    __device__ __forceinline__ void operator()(const f32x4 (&acc)[2][2][4][2], const Unit& u, int wr, int wc, int fr, int fq) const {
        const int row0 = u.pm * BM + wr * 64 + fr, col0 = u.pn * HALF + wc * 32 + 8 * fq;
#pragma unroll
        for (int ai = 0; ai < 2; ++ai)
#pragma unroll
            for (int m = 0; m < 4; ++m) {
                float r[8];
#pragma unroll
                for (int n = 0; n < 2; ++n)
#pragma unroll
                    for (int e = 0; e < 4; ++e) { const float g = acc[ai][0][m][n][e], up = acc[ai][1][m][n][e];
                        r[4 * n + e] = g * __builtin_amdgcn_rcpf(1.0f + __builtin_amdgcn_exp2f(-1.4426950408889634f * g)) * up; }
                u32x4 w; w.x = cvt_pk_bf16(r[0], r[1]); w.y = cvt_pk_bf16(r[2], r[3]); w.z = cvt_pk_bf16(r[4], r[5]); w.w = cvt_pk_bf16(r[6], r[7]);
                *(u32x4*)(O + (size_t)(row0 + ai * HALF + m * 16) * ldc + col0) = w;
            }
    }
};
struct EpiWin {
    static constexpr bool PERM = true, AFTER_DRAIN = false;
    bf16_t *Qb, *Kb, *Vb, *Ub, *Gb; float *kp, *vp, *ks, *vs;
    __device__ __forceinline__ void operator()(const f32x4 (&acc)[2][2][4][2], const Unit& u, int wr, int wc, int fr, int fq) const {
        const int type = u.pn >> 1, row0 = u.pm * BM + wr * 64 + fr, col0 = (u.pn & 1) * BM + wc * 32 + 8 * fq;
        bf16_t* ob = type == 0 ? Qb : type == 1 ? Kb : type == 2 ? Vb : type == 3 ? Ub : Gb;
        float* of = nullptr;
        if (type == 1) of = (u.pm < 64) ? kp + (size_t)row0 * 512 : ks + (size_t)(row0 - 16384) * 512;
        if (type == 2) of = (u.pm < 64) ? vp + (size_t)row0 * 512 : vs + (size_t)(row0 - 16384) * 512;
        const float sc = type == 0 ? 0.125f * 1.4426950408889634f : 1.0f;
#pragma unroll
        for (int ai = 0; ai < 2; ++ai)
#pragma unroll
            for (int m = 0; m < 4; ++m) {
                const int rr = ai * HALF + m * 16;
#pragma unroll
                for (int bj = 0; bj < 2; ++bj) {
                    f32x4 v0 = acc[ai][bj][m][0], v1 = acc[ai][bj][m][1];
                    if (type >= 3) { f32x2 a = gelu_pk((f32x2){v0[0], v0[1]}), b = gelu_pk((f32x2){v0[2], v0[3]}), c = gelu_pk((f32x2){v1[0], v1[1]}), d = gelu_pk((f32x2){v1[2], v1[3]});
                        v0 = (f32x4){a.x, a.y, b.x, b.y}; v1 = (f32x4){c.x, c.y, d.x, d.y}; }
                    if (of) { float* p = of + (size_t)rr * 512 + col0 + bj * HALF; *(f32x4*)p = v0; *(f32x4*)(p + 4) = v1; }
                    v0 = v0 * sc; v1 = v1 * sc;
                    u32x4 w; w.x = cvt_pk_bf16(v0[0], v0[1]); w.y = cvt_pk_bf16(v0[2], v0[3]); w.z = cvt_pk_bf16(v1[0], v1[1]); w.w = cvt_pk_bf16(v1[2], v1[3]);
                    *(u32x4*)(ob + (size_t)(row0 + rr) * 512 + col0 + bj * HALF) = w;
                }
            }
    }
};
}

__device__ __forceinline__ void p0_transpose_item(const float* W, int K, int N, bf16* WT, int mode, LAS float* scr, int item, int lane) {
    const int nblk = N / 32, kb = item / nblk, nb = item % nblk, k0 = 64 * kb, n0 = 32 * nb;
    const int r0 = mode == 0 ? n0 : (256 * (n0 >> 7) + (n0 & 127) + (mode == 2 ? 128 : 0));
#pragma unroll 8
    for (int i = 0; i < 32; ++i) { const int kk = 2 * i + (lane >> 5); scr[kk * 33 + (lane & 31)] = W[(size_t)(k0 + kk) * N + n0 + (lane & 31)]; }
    asm volatile("s_waitcnt lgkmcnt(0)" ::: "memory");
    const int c = lane & 7;
#pragma unroll
    for (int j = 0; j < 4; ++j) { const int n = (lane >> 3) + 8 * j; const LAS float* s = scr + (8 * c) * 33 + n;
        u32x4 o; o.x = cvtpk(s[0 * 33], s[1 * 33]); o.y = cvtpk(s[2 * 33], s[3 * 33]); o.z = cvtpk(s[4 * 33], s[5 * 33]); o.w = cvtpk(s[6 * 33], s[7 * 33]);
        *(u32x4*)(WT + (size_t)(r0 + n) * K + k0 + 8 * c) = o; }
    asm volatile("s_waitcnt lgkmcnt(0)" ::: "memory");
}

template <int MODE>
__device__ __forceinline__ void row_pass(const float* xin, const bf16* F, float coef, const float* gpost, float* xout, const float* gpre, bf16* xn, int lane) {
    f32x4 v[4];
#pragma unroll
    for (int j = 0; j < 4; ++j) v[j] = *((const f32x4*)xin + lane + 64 * j);
    if (MODE != 0) {
        f32x4 f[4]; float s = 0.f;
#pragma unroll
        for (int j = 0; j < 4; ++j) { const u32x2 w = *((const u32x2*)F + lane + 64 * j); f[j] = (f32x4){bflo(w.x), bfhi(w.x), bflo(w.y), bfhi(w.y)};
            s += (f[j].x * f[j].x + f[j].y * f[j].y) + (f[j].z * f[j].z + f[j].w * f[j].w); }
        const float r = coef * __builtin_amdgcn_rsqf(wave_sum(s) * (1.f / DM) + EPSN);
#pragma unroll
        for (int j = 0; j < 4; ++j) { const f32x4 g = *((const f32x4*)gpost + lane + 64 * j); v[j] = v[j] + f[j] * g * r; *((f32x4*)xout + lane + 64 * j) = v[j]; }
    }
    if (MODE != 2) {
        float s = 0.f;
#pragma unroll
        for (int j = 0; j < 4; ++j) s += (v[j].x * v[j].x + v[j].y * v[j].y) + (v[j].z * v[j].z + v[j].w * v[j].w);
        const float r = __builtin_amdgcn_rsqf(wave_sum(s) * (1.f / DM) + EPSN);
#pragma unroll
        for (int j = 0; j < 4; ++j) { const f32x4 g = *((const f32x4*)gpre + lane + 64 * j); const f32x4 o = v[j] * g * r;
            u32x2 w; w.x = cvtpk(o.x, o.y); w.y = cvtpk(o.z, o.w); *((u32x2*)xn + lane + 64 * j) = w; }
    }
}
__device__ __forceinline__ void merge_pass(bf16* row, const float* gsb, const float* gsgu, int lane) {
#pragma unroll
    for (int j = 0; j < 2; ++j) {
        const u32x4 w = *((const u32x4*)row + lane + 64 * j);
        float x[8] = {bflo(w.x), bfhi(w.x), bflo(w.y), bfhi(w.y), bflo(w.z), bfhi(w.z), bflo(w.w), bfhi(w.w)};
        float s = 0.f;
#pragma unroll
        for (int e = 0; e < 8; ++e) s += x[e] * x[e];
        const float r = __builtin_amdgcn_rsqf(wave_sum(s) * (1.f / HW) + EPSN);
        const float* g = (j == 0 ? gsb : gsgu) + lane * 8;
        const f32x4 g0 = *(const f32x4*)g, g1 = *(const f32x4*)(g + 4);
        u32x4 o; o.x = cvtpk(x[0] * r * g0.x, x[1] * r * g0.y); o.y = cvtpk(x[2] * r * g0.z, x[3] * r * g0.w);
        o.z = cvtpk(x[4] * r * g1.x, x[5] * r * g1.y); o.w = cvtpk(x[6] * r * g1.z, x[7] * r * g1.w);
        *((u32x4*)row + lane + 64 * j) = o;
    }
}

namespace sbk {
constexpr int ROWB = 144, TILEB = 64 * ROWB, BUFB = 2 * TILEB, FLAG_OFF = 2 * BUFB;
__device__ __forceinline__ void attn_unit(LAS unsigned char* lds, const bf16* Qb, const bf16* Kb, const bf16* Vb, const float* cK, const float* cV, bf16* MG,
                                          const bool smp, const int b, const int h, const int qb) {
    const int tid = threadIdx.x, lane = tid & 63, q = lane & 31, hi = lane >> 5, w = __builtin_amdgcn_readfirstlane(tid >> 6);
    const int rowQ0 = smp ? NP + b * DSEQ : b * SEQ + 256 * qb;
    const int qpos_u0 = smp ? PAST : 256 * qb;
    const int nq = smp ? DSEQ : 256;
    const int kt_top = smp ? 32 : 4 * qb + 3;
    const bool active = 32 * w < nq;
    const int qpos0 = qpos_u0 + 32 * w, ktw = (qpos0 + 30) >> 6, qpos = qpos0 + q;
    bf16x8 qf[4];
#pragma unroll
    for (int ds = 0; ds < 4; ++ds) qf[ds] = active ? *(const bf16x8*)(Qb + (size_t)(rowQ0 + 32 * w + q) * HW + h * 64 + 16 * ds + 8 * hi) : (bf16x8){0, 0, 0, 0, 0, 0, 0, 0};
    f32x16 O0, O1;
#pragma unroll
    for (int i = 0; i < 16; ++i) { O0[i] = 0.f; O1[i] = 0.f; }
    float carry = 1.f; bool wdone = !active;
    const int lkey = tid >> 3, lch = tid & 7;
    f32x4 ra, rb, rc, rd; bool srcf = false;
    LAS unsigned* flags = (LAS unsigned*)(lds + FLAG_OFF);
#define SB_LOAD(kt_) do { const int pos_ = 64 * (kt_) + lkey; \
        if (smp && (kt_) < 32) { srcf = true; const size_t o_ = (((size_t)(b * PAST + pos_) * 8 + h) * 64 + lch * 8); \
            ra = *(const f32x4*)(cK + o_); rb = *(const f32x4*)(cK + o_ + 4); rc = *(const f32x4*)(cV + o_); rd = *(const f32x4*)(cV + o_ + 4); } \
        else { srcf = false; const size_t row_ = smp ? (size_t)(NP + b * DSEQ + (pos_ - PAST)) : (size_t)(b * SEQ + pos_); \
            ra = *(const f32x4*)(Kb + row_ * HW + h * 64 + lch * 8); rc = *(const f32x4*)(Vb + row_ * HW + h * 64 + lch * 8); } } while (0)
#define SB_STORE(buf_) do { u32x4 kk_, vv_; \
        if (srcf) { kk_.x = cvtpk(ra.x, ra.y); kk_.y = cvtpk(ra.z, ra.w); kk_.z = cvtpk(rb.x, rb.y); kk_.w = cvtpk(rb.z, rb.w); \
                    vv_.x = cvtpk(rc.x, rc.y); vv_.y = cvtpk(rc.z, rc.w); vv_.z = cvtpk(rd.x, rd.y); vv_.w = cvtpk(rd.z, rd.w); } \
        else { kk_ = __builtin_bit_cast(u32x4, ra); vv_ = __builtin_bit_cast(u32x4, rc); } \
        *(LAS u32x4*)(lds + (buf_) * BUFB + lkey * ROWB + lch * 16) = kk_; \
        LAS unsigned short* vt_ = (LAS unsigned short*)(lds + (buf_) * BUFB + TILEB) + lkey; \
        _Pragma("unroll") for (int e_ = 0; e_ < 4; ++e_) { vt_[(lch * 8 + 2 * e_) * (ROWB / 2)] = (unsigned short)(vv_[e_] & 0xffffu); vt_[(lch * 8 + 2 * e_ + 1) * (ROWB / 2)] = (unsigned short)(vv_[e_] >> 16); } } while (0)
    SB_LOAD(kt_top); SB_STORE(0);
    __syncthreads();
    const int krow = 32 * ((q >> 2) & 1) + (q & 3) + 4 * (q >> 3);
    int it = 0;
    for (int kt = kt_top; kt >= 0; --kt, ++it) {
        const int buf = it & 1;
        if (kt > 0) SB_LOAD(kt - 1);
        if (!wdone && kt <= ktw) {
            const LAS unsigned char* Kl = lds + buf * BUFB; const LAS unsigned char* Vl = Kl + TILEB;
            f32x16 X, Y;
#pragma unroll
            for (int i = 0; i < 16; ++i) { X[i] = 0.f; Y[i] = 0.f; }
#pragma unroll
            for (int ds = 0; ds < 4; ++ds) {
                const bf16x8 ka = *(const LAS bf16x8*)(Kl + krow * ROWB + (16 * ds + 8 * hi) * 2);
                const bf16x8 kb2 = *(const LAS bf16x8*)(Kl + (krow + 16) * ROWB + (16 * ds + 8 * hi) * 2);
                X = MFMA32(ka, qf[ds], X); Y = MFMA32(kb2, qf[ds], Y);
            }
            const int kbase = 64 * kt + 32 * hi;
            float run = 1.f;
#define SB_EL(V_, idx_, MASK_) do { const float e_ = __builtin_amdgcn_exp2f(-(V_)); float bt_ = __builtin_amdgcn_rcpf(1.0f + e_); float om_ = 1.0f - bt_; \
            if (MASK_) { const bool ok_ = (kbase + (idx_)) < qpos; bt_ = ok_ ? bt_ : 0.f; om_ = ok_ ? om_ : 1.f; } (V_) = bt_ * run; run *= om_; } while (0)
            if (64 * kt + 63 >= qpos0) {
#pragma unroll
                for (int i = 15; i >= 0; --i) SB_EL(Y[i], 16 + i, true);
#pragma unroll
                for (int i = 15; i >= 0; --i) SB_EL(X[i], i, true);
            } else {
#pragma unroll
                for (int i = 15; i >= 0; --i) SB_EL(Y[i], 16 + i, false);
#pragma unroll
                for (int i = 15; i >= 0; --i) SB_EL(X[i], i, false);
            }
            const float tot = run, ptot = __shfl_xor(tot, 32);
            const float base = carry * (hi ? 1.f : ptot);
            carry *= tot * ptot;
#pragma unroll
            for (int i = 0; i < 16; ++i) { X[i] *= base; Y[i] *= base; }
            bf16x8 pf[4];
            pf[0] = pack8(X[0], X[1], X[2], X[3], X[4], X[5], X[6], X[7]); pf[1] = pack8(X[8], X[9], X[10], X[11], X[12], X[13], X[14], X[15]);
            pf[2] = pack8(Y[0], Y[1], Y[2], Y[3], Y[4], Y[5], Y[6], Y[7]); pf[3] = pack8(Y[8], Y[9], Y[10], Y[11], Y[12], Y[13], Y[14], Y[15]);
#pragma unroll
            for (int s = 0; s < 4; ++s) {
                const bf16x8 v0 = *(const LAS bf16x8*)(Vl + q * ROWB + (32 * hi + 8 * s) * 2);
                const bf16x8 v1 = *(const LAS bf16x8*)(Vl + (32 + q) * ROWB + (32 * hi + 8 * s) * 2);
                O0 = MFMA32(pf[s], v0, O0); O1 = MFMA32(pf[s], v1, O1);
            }
#ifndef SB_NO_EXIT
            wdone = __all(carry < 1.17549435e-38f);
#endif
        }
        if (lane == 0) flags[buf * 8 + w] = wdone ? 1u : 0u;
        if (kt > 0) SB_STORE(buf ^ 1);
        __syncthreads();
        const unsigned f = flags[buf * 8 + (lane & 7)];
        if (__all(f != 0u)) break;
    }
#undef SB_EL
#undef SB_LOAD
#undef SB_STORE
    if (active) {
#pragma unroll
        for (int i = 0; i < 16; ++i) { bf16* o = MG + (size_t)(rowQ0 + 32 * w + crow(i, hi)) * DM + h * 64 + q; o[0] = f2bf(O0[i]); o[32] = f2bf(O1[i]); }
    }
}
}

__device__ __forceinline__ void sgu_unit(LAS unsigned char* lds, const bf16* Gb, const bf16* Ub, const bf16* Wsb, const float* lng, const float* lnb, const float* bs,
                                         bf16* MG, float* out_g, const bool smp, const int c, const int gh) {
    const int tid = threadIdx.x, lane = tid & 63, d = lane & 31, hi = lane >> 5, w = __builtin_amdgcn_readfirstlane(tid >> 6);
    const int row0 = smp ? NP + DSEQ * c : 128 * c, J = smp ? DSEQ : 128;
    LAS f32x2* st = (LAS f32x2*)lds;
    for (int j = w; j < J; j += 8) {
        const u32x4 raw = *((const u32x4*)(Gb + (size_t)(row0 + j) * HW) + lane);
        float x[8] = {bflo(raw.x), bfhi(raw.x), bflo(raw.y), bfhi(raw.y), bflo(raw.z), bfhi(raw.z), bflo(raw.w), bfhi(raw.w)};
        float s = 0.f;
#pragma unroll
        for (int e = 0; e < 8; ++e) s += x[e];
        const float mean = wave_sum(s) * (1.f / HW); float s2 = 0.f;
#pragma unroll
        for (int e = 0; e < 8; ++e) { const float dd = x[e] - mean; s2 += dd * dd; }
        const float rstd = __builtin_amdgcn_rsqf(wave_sum(s2) * (1.f / HW) + EPSN);
        if (lane == 0) st[j] = (f32x2){mean, rstd};
    }
    __syncthreads();
    const int gg = 4 * gh + (w >> 1), ih = w & 1;
    if (64 * ih < J) {
        const int njb = ih ? 4 : 2;
        f32x16 acc[2][2];
#pragma unroll
        for (int a = 0; a < 2; ++a)
#pragma unroll
            for (int bb = 0; bb < 2; ++bb)
#pragma unroll
                for (int i = 0; i < 16; ++i) acc[a][bb][i] = 0.f;
        bf16x8 If[2];
#pragma unroll
        for (int s = 0; s < 2; ++s)
#pragma unroll
            for (int jj = 0; jj < 8; ++jj) If[s][jj] = (d == 16 * s + 8 * hi + jj) ? (short)0x3F80 : (short)0;
        const int prow = 16 * ((d >> 2) & 1) + (d & 3) + 4 * (d >> 3);
        for (int jb = 0; jb < njb; ++jb) {
            bf16x8 Bf[2][2];
#pragma unroll
            for (int dblk = 0; dblk < 2; ++dblk) {
                f32x16 X;
#pragma unroll
                for (int i = 0; i < 16; ++i) X[i] = 0.f;
#pragma unroll
                for (int s = 0; s < 2; ++s) { const bf16x8 a = *(const bf16x8*)(Gb + (size_t)(row0 + 32 * jb + prow) * HW + 64 * gg + 32 * dblk + 16 * s + 8 * hi); X = MFMA32(a, If[s], X); }
                const float gam = lng[64 * gg + 32 * dblk + d], bet = lnb[64 * gg + 32 * dblk + d];
#pragma unroll
                for (int i = 0; i < 16; ++i) { const f32x2 ms = st[32 * jb + 16 * hi + i]; X[i] = (X[i] - ms.x) * ms.y * gam + bet; }
                if (smp && ih == 0) {
#pragma unroll
                    for (int i = 0; i < 16; ++i) out_g[(size_t)(row0 - NP + 32 * jb + 16 * hi + i) * HW + 64 * gg + 32 * dblk + d] = X[i];
                }
                Bf[dblk][0] = pack8(X[0], X[1], X[2], X[3], X[4], X[5], X[6], X[7]); Bf[dblk][1] = pack8(X[8], X[9], X[10], X[11], X[12], X[13], X[14], X[15]);
            }
#pragma unroll
            for (int iblk = 0; iblk < 2; ++iblk)
#pragma unroll
                for (int s = 0; s < 2; ++s) {
                    const bf16x8 wf = *(const bf16x8*)(Wsb + ((size_t)gg * 128 + 64 * ih + 32 * iblk + d) * 128 + 32 * jb + 16 * hi + 8 * s);
                    acc[iblk][0] = MFMA32(wf, Bf[0][s], acc[iblk][0]); acc[iblk][1] = MFMA32(wf, Bf[1][s], acc[iblk][1]);
                }
        }
#pragma unroll
        for (int iblk = 0; iblk < 2; ++iblk)
#pragma unroll
            for (int i = 0; i < 16; ++i) {
                const int irow = 64 * ih + 32 * iblk + crow(i, hi); const float bsv = bs[gg * 128 + irow];
#pragma unroll
                for (int dblk = 0; dblk < 2; ++dblk) { const int col = 64 * gg + 32 * dblk + d;
                    const float uu = bf2f(Ub[(size_t)(row0 + irow) * HW + col]);
                    MG[(size_t)(row0 + irow) * DM + HW + col] = f2bf(uu * (acc[iblk][dblk][i] + bsv)); }
            }
    }
    __syncthreads();
}

struct Args { const float* in[24]; float* out; unsigned char* ws; int ph_lo, ph_hi, coop, pad; };

__global__ void __launch_bounds__(512, 2) fwd_kernel(Args args) {
    extern __shared__ __attribute__((aligned(16))) unsigned char lds_raw[];
    LAS unsigned char* lds = (LAS unsigned char*)lds_raw;
    const int tid = threadIdx.x, lane = tid & 63, wave = __builtin_amdgcn_readfirstlane(tid >> 6);
    const int G = gridDim.x, bx = blockIdx.x;
    const int vcu = (G % 8 == 0) ? (bx % 8) * (G / 8) + bx / 8 : bx;
    const int gw = vcu * 8 + wave, NGW = G * 8;
    unsigned char* ws = args.ws; float* out = args.out;
    const float *xp = args.in[0], *xs = args.in[1], *cK = args.in[2], *cV = args.in[3];
    bf16 *Wgu1 = (bf16*)(ws + WS_WGU1), *Wd1 = (bf16*)(ws + WS_WD1), *Win = (bf16*)(ws + WS_WIN), *Wout = (bf16*)(ws + WS_WOUT), *Wgu2 = (bf16*)(ws + WS_WGU2), *Wd2 = (bf16*)(ws + WS_WD2), *Wsb = (bf16*)(ws + WS_WSB);
    bf16 *XN = (bf16*)(ws + WS_XN), *Fb = (bf16*)(ws + WS_F), *MG = (bf16*)(ws + WS_MG), *ACT = (bf16*)(ws + WS_ACT);
    bf16 *Qb = (bf16*)(ws + WS_Q), *Kb = (bf16*)(ws + WS_K), *Vb = (bf16*)(ws + WS_V), *Ub = (bf16*)(ws + WS_U), *Gb = (bf16*)(ws + WS_G);
    const int lo = args.ph_lo, hi = args.ph_hi;
#define IN(k) (lo <= (k) && (k) < hi)
#define SEAM(k) do { if (IN(k) && IN((k) + 1)) { cg::this_grid().sync(); } } while (0)

    if (IN(0)) {
        LAS float* scr = (LAS float*)(lds + wave * 16384);
        constexpr int I_UP = (DM / 64) * (DFF / 32), I_DN = (DFF / 64) * (DM / 32), I_IN = (DM / 64) * (DIN / 32), I_OUT = (DM / 64) * (DM / 32);
        constexpr int NITEMS = 6 * I_UP + I_IN + I_OUT; static_assert(I_UP == I_DN, "items");
        for (int it = gw; it < NITEMS; it += NGW) {
            int r = it;
            if (r < I_UP) { p0_transpose_item(args.in[6], DM, DFF, Wgu1, 1, scr, r, lane); continue; } r -= I_UP;
            if (r < I_UP) { p0_transpose_item(args.in[7], DM, DFF, Wgu1, 2, scr, r, lane); continue; } r -= I_UP;
            if (r < I_DN) { p0_transpose_item(args.in[8], DFF, DM, Wd1, 0, scr, r, lane); continue; } r -= I_DN;
            if (r < I_UP) { p0_transpose_item(args.in[21], DM, DFF, Wgu2, 1, scr, r, lane); continue; } r -= I_UP;
            if (r < I_UP) { p0_transpose_item(args.in[22], DM, DFF, Wgu2, 2, scr, r, lane); continue; } r -= I_UP;
            if (r < I_DN) { p0_transpose_item(args.in[23], DFF, DM, Wd2, 0, scr, r, lane); continue; } r -= I_DN;
            if (r < I_IN) { p0_transpose_item(args.in[11], DM, DIN, Win, 0, scr, r, lane); continue; } r -= I_IN;
            p0_transpose_item(args.in[18], DM, DM, Wout, 0, scr, r, lane);
        }
        for (int i = bx * 512 + tid; i < 8 * 128 * 128; i += G * 512) { const int ii = (i >> 7) & 127, jj = i & 127; Wsb[i] = ((jj >> 6) <= (ii >> 6)) ? f2bf(args.in[14][i]) : (bf16)0; }
        for (int m = gw; m < MTOT; m += NGW) { const float* xr = m < NP ? xp + (size_t)m * DM : xs + (size_t)(m - NP) * DM;
            row_pass<0>(xr, nullptr, 0.f, nullptr, nullptr, args.in[4], XN + (size_t)m * DM, lane); }
        __syncthreads();
    }
    SEAM(0);
    if (IN(1)) {
        pg8::Gemm g{XN, Wgu1, MTOT, 2 * DFF, DM}; pg8::StaticOrder S; S.init(MTOT, 2 * DFF, G, bx);
        pg8::EpiSwiGLU E{ACT, DFF};
        pg8::gemm_phase<pg8::EpiSwiGLU, pg8::StaticOrder, PG8_ALIGN, PG8_SP2>(lds, g, S, E);
    }
    SEAM(1);
    if (IN(2)) {
        pg8::Gemm g{ACT, Wd1, MTOT, DM, DFF}; pg8::StaticOrder S; S.init(MTOT, DM, G, bx);
        pg8::EpiBf16<0> E{Fb, DM, nullptr, 0, 0, 1.f};
        pg8::gemm_phase<pg8::EpiBf16<0>, pg8::StaticOrder, PG8_ALIGN, PG8_SP2>(lds, g, S, E);
    }
    SEAM(2);
    if (IN(3)) {
        for (int m = gw; m < MTOT; m += NGW) { const float* xr = m < NP ? xp + (size_t)m * DM : xs + (size_t)(m - NP) * DM;
            row_pass<1>(xr, Fb + (size_t)m * DM, 0.5f, args.in[5], out + O_Y + (size_t)m * DM, args.in[9], XN + (size_t)m * DM, lane); }
    }
    SEAM(3);
    if (IN(4)) {
        pg8::Gemm g{XN, Win, MTOT, DIN, DM}; pg8::StaticOrder S; S.init(MTOT, DIN, G, bx);
        pg8::EpiWin E{Qb, Kb, Vb, Ub, Gb, out + O_KP, out + O_VP, out + O_KS, out + O_VS};
        pg8::gemm_phase<pg8::EpiWin, pg8::StaticOrder, PG8_ALIGN, PG8_SP2>(lds, g, S, E);
    }
    SEAM(4);
    if (IN(5)) {
        for (int u = vcu; u < 256; u += G) { const int bh = u >> 3, s = u & 7;
            sbk::attn_unit(lds, Qb, Kb, Vb, cK, cV, MG, false, bh >> 3, bh & 7, 15 - s);
            sbk::attn_unit(lds, Qb, Kb, Vb, cK, cV, MG, false, bh >> 3, bh & 7, s); }
        for (int u = G - 1 - vcu; u < 64; u += G) sbk::attn_unit(lds, Qb, Kb, Vb, cK, cV, MG, true, u >> 3, u & 7, 0);
        __syncthreads();
        for (int u = vcu; u < 272; u += G) {
            if (u < 256) sgu_unit(lds, Gb, Ub, Wsb, args.in[12], args.in[13], args.in[15], MG, out + O_GS, false, u >> 1, u & 1);
            else sgu_unit(lds, Gb, Ub, Wsb, args.in[12], args.in[13], args.in[15], MG, out + O_GS, true, (u - 256) >> 1, u & 1);
        }
    }
    SEAM(5);
    if (IN(6)) { for (int m = gw; m < MTOT; m += NGW) merge_pass(MG + (size_t)m * DM, args.in[16], args.in[17], lane); }
    SEAM(6);
    if (IN(7)) {
        pg8::Gemm g{MG, Wout, MTOT, DM, DM}; pg8::StaticOrder S; S.init(MTOT, DM, G, bx);
        pg8::EpiBf16<0> E{Fb, DM, nullptr, 0, 0, 1.f};
        pg8::gemm_phase<pg8::EpiBf16<0>, pg8::StaticOrder, PG8_ALIGN, PG8_SP2>(lds, g, S, E);
    }
    SEAM(7);
    if (IN(8)) {
        for (int m = gw; m < MTOT; m += NGW) { float* xr = out + O_Y + (size_t)m * DM;
            row_pass<1>(xr, Fb + (size_t)m * DM, 1.0f, args.in[10], xr, args.in[19], XN + (size_t)m * DM, lane); }
    }
    SEAM(8);
    if (IN(9)) {
        pg8::Gemm g{XN, Wgu2, MTOT, 2 * DFF, DM}; pg8::StaticOrder S; S.init(MTOT, 2 * DFF, G, bx);
        pg8::EpiSwiGLU E{ACT, DFF};
        pg8::gemm_phase<pg8::EpiSwiGLU, pg8::StaticOrder, PG8_ALIGN, PG8_SP2>(lds, g, S, E);
    }
    SEAM(9);
    if (IN(10)) {
        pg8::Gemm g{ACT, Wd2, MTOT, DM, DFF}; pg8::StaticOrder S; S.init(MTOT, DM, G, bx);
        pg8::EpiBf16<0> E{Fb, DM, nullptr, 0, 0, 1.f};
        pg8::gemm_phase<pg8::EpiBf16<0>, pg8::StaticOrder, PG8_ALIGN, PG8_SP2>(lds, g, S, E);
    }
    SEAM(10);
    if (IN(11)) {
        for (int m = gw; m < MTOT; m += NGW) { float* xr = out + O_Y + (size_t)m * DM;
            row_pass<2>(xr, Fb + (size_t)m * DM, 0.5f, args.in[20], xr, nullptr, nullptr, lane); }
    }
#undef IN
#undef SEAM
}

extern "C" void kernel_launch(void* const* d_in, const int* in_sizes, int n_in, void* d_out, int out_size, void* d_ws, size_t ws_size, hipStream_t stream) {
    static int grid = 0;
    if (grid == 0) {
        if (n_in != 24 || ws_size < WS_END) { fprintf(stderr, "kernel_launch: unexpected problem (n_in %d, ws %zu)\n", n_in, ws_size); grid = -1; return; }
        int dev = 0, cus = 0, per_cu = 0;
        if (hipGetDevice(&dev) != hipSuccess || hipDeviceGetAttribute(&cus, hipDeviceAttributeMultiprocessorCount, dev) != hipSuccess) { grid = -1; return; }
        if (hipFuncSetAttribute((const void*)fwd_kernel, hipFuncAttributeMaxDynamicSharedMemorySize, LDS_BYTES) != hipSuccess) { fprintf(stderr, "kernel_launch: hipFuncSetAttribute failed\n"); grid = -1; return; }
        if (hipOccupancyMaxActiveBlocksPerMultiprocessor(&per_cu, (const void*)fwd_kernel, 512, LDS_BYTES) != hipSuccess || per_cu < 1) { fprintf(stderr, "kernel_launch: occupancy query says %d\n", per_cu); per_cu = 1; }
        (void)hipGetLastError();
        grid = cus * per_cu;
    }
    if (grid < 0) return;
    Args a{};
    for (int i = 0; i < 24; ++i) a.in[i] = (const float*)d_in[i];
    a.out = (float*)d_out; a.ws = (unsigned char*)d_ws;
#if MK_N_LAUNCHES == 1
    a.ph_lo = 0; a.ph_hi = N_PHASES; a.coop = 1;
    void* kargs[] = {&a};
    hipError_t e = hipLaunchCooperativeKernel((const void*)fwd_kernel, dim3(grid), dim3(512), kargs, LDS_BYTES, stream);
    if (e != hipSuccess) fprintf(stderr, "kernel_launch: cooperative launch failed: %s (grid %d)\n", hipGetErrorString(e), grid);
#else
    for (int p = 0; p < N_PHASES; ++p) { a.ph_lo = p; a.ph_hi = p + 1; a.coop = 0; hipLaunchKernelGGL(fwd_kernel, dim3(grid), dim3(512), LDS_BYTES, stream, a); }
#endif
}
```
